# Optimizing an MI355X kernel written in HIP

```python
import jax, jax.numpy as jnp
from jax import lax
import numpy as np

D_MODEL = 1024
BATCH = 8
SEQ = 2048
DEPTH = 1
DEC_BATCH = 16
DEC_SEQ = 32
PAST_LEN = 2048

CHUNK = 64
D_MIX = D_MODEL
D_CONV = D_MIX // 2
CONV_WIDTH = 31
CONV_BUF = CONV_WIDTH - 1
D_HGRN = D_MIX - D_CONV
HGRN_HEADS = 4
HGRN_DK = D_HGRN // HGRN_HEADS
HGRN_DV = D_HGRN // HGRN_HEADS
D_IN = 2 * D_CONV + 4 * D_HGRN
SPLITS = (D_CONV, 2 * D_CONV, 2 * D_CONV + D_HGRN, 2 * D_CONV + 2 * D_HGRN, 2 * D_CONV + 3 * D_HGRN)
N_MEM = 256
MEM_HEADS = 4
MEM_HEAD_DIM = D_MODEL // MEM_HEADS
D_FF = 2816
EPS = 1e-6

kernel_name = 'hymba_conformer_hgrn2_streaming_step'


def rms_norm(x, g):
    xf = x.astype(jnp.float32)
    y = xf * lax.rsqrt(jnp.mean(xf * xf, axis=-1, keepdims=True) + EPS)
    return (y * g.astype(jnp.float32)).astype(x.dtype)


def layer_norm(x, g, b):
    xf = x.astype(jnp.float32)
    mu = jnp.mean(xf, axis=-1, keepdims=True)
    var = jnp.mean(jnp.square(xf - mu), axis=-1, keepdims=True)
    y = (xf - mu) * lax.rsqrt(var + EPS)
    return (y * g.astype(jnp.float32) + b.astype(jnp.float32)).astype(x.dtype)


def swiglu(x, w_gate, w_up, w_down):
    return (jax.nn.silu(x @ w_gate) * (x @ w_up)) @ w_down


def hgrn_chunk(s0, q, k, v, logf):
    c = q.shape[1]
    g_cum = jnp.cumsum(logf, axis=1)
    g_last = g_cum[:, -1]
    q_dec = q * jnp.exp(g_cum)
    k_dec = k * jnp.exp(-g_cum)
    a = jnp.einsum('bthk,bshk->bhts', q_dec, k_dec)
    a = jnp.where(jnp.tril(jnp.ones((c, c), dtype=bool)), a, 0.0)
    o = jnp.einsum('bhts,bshv->bthv', a, v) + jnp.einsum('bthk,bhkv->bthv', q_dec, s0)
    k_end = k * jnp.exp(g_last[:, None] - g_cum)
    s1 = s0 * jnp.exp(g_last)[..., None] + jnp.einsum('bshk,bshv->bhkv', k_end, v)
    return s1, o


def hgrn_recurrence(s0, q, k, v, logf):
    b, t = q.shape[:2]
    c = min(CHUNK, t)
    n = t // c

    def to_blocks(a):
        return a.reshape(b, n, c, *a.shape[2:]).swapaxes(0, 1)

    def step(s, xs):
        return hgrn_chunk(s, *xs)

    s1, o = lax.scan(step, s0, (to_blocks(q), to_blocks(k), to_blocks(v), to_blocks(logf)))
    o = o.swapaxes(0, 1).reshape(b, t, HGRN_HEADS, HGRN_DV)
    return s1, o


def conv_group(c_val, c_gate, buf, w_dw, b_dw, ln_g, ln_b):
    u = c_val * jax.nn.sigmoid(c_gate)
    u_ext = jnp.concatenate([buf.astype(u.dtype), u], axis=1)
    y = lax.conv_general_dilated(
        u_ext, w_dw[:, None, :].astype(u.dtype), window_strides=(1,), padding='VALID',
        dimension_numbers=('NWC', 'WIO', 'NWC'), feature_group_count=D_CONV) + b_dw
    y = jax.nn.silu(layer_norm(y, ln_g, ln_b))
    return y, u_ext[:, -CONV_BUF:]


def hgrn_group(hq, hf, hi, hg, s0, lb, g_norm):
    b, t, _ = hq.shape

    def heads(a):
        return a.astype(jnp.float32).reshape(b, t, HGRN_HEADS, -1)

    lbh = lb.reshape(HGRN_HEADS, HGRN_DK)
    f = lbh + (1.0 - lbh) * jax.nn.sigmoid(heads(hf))
    q = jax.nn.silu(heads(hq))
    s1, o = hgrn_recurrence(s0.astype(jnp.float32), q, 1.0 - f, heads(hi), jnp.log(f))
    o = rms_norm(o, g_norm) * jax.nn.silu(heads(hg))
    return o.reshape(b, t, D_HGRN).astype(hq.dtype), s1


def mem_kv(mem, g, wk, wv):
    b = mem.shape[0]
    m = rms_norm(mem, g)
    k = (m @ wk).reshape(b, N_MEM, MEM_HEADS, MEM_HEAD_DIM)
    v = (m @ wv).reshape(b, N_MEM, MEM_HEADS, MEM_HEAD_DIM)
    return k, v


def mem_attend(h, k, v, wq, wo):
    b, t, _ = h.shape
    q = (h @ wq).reshape(b, t, MEM_HEADS, MEM_HEAD_DIM)
    s = jnp.einsum('bthd,bmhd->bhtm', q, k).astype(jnp.float32) * (MEM_HEAD_DIM ** -0.5)
    p = jax.nn.softmax(s, axis=-1).astype(v.dtype)
    o = jnp.einsum('bhtm,bmhd->bthd', p, v).reshape(b, t, D_MODEL)
    return o @ wo


def encoder_layer(x, conv_buf, s0, mk, mv, lb, w):
    x = x + 0.5 * swiglu(rms_norm(x, w['ffn1_norm']), w['ffn1_w_gate'], w['ffn1_w_up'], w['ffn1_w_down'])
    z = rms_norm(x, w['mix_norm']) @ w['w_in']
    c_val, c_gate, hq, hf, hi, hg = jnp.split(z, SPLITS, axis=-1)
    y_conv, new_buf = conv_group(c_val, c_gate, conv_buf, w['conv_dw'], w['conv_dw_b'],
                                 w['conv_ln_g'], w['conv_ln_b'])
    y_hgrn, new_s = hgrn_group(hq, hf, hi, hg, s0, lb, w['hgrn_norm'])
    x = x + jnp.concatenate([y_conv, y_hgrn], axis=-1) @ w['w_out']
    x = x + mem_attend(rms_norm(x, w['xattn_norm']), mk, mv, w['xattn_wq'], w['xattn_wo'])
    x = x + 0.5 * swiglu(rms_norm(x, w['ffn2_norm']), w['ffn2_w_gate'], w['ffn2_w_up'], w['ffn2_w_down'])
    return x, new_buf, new_s


def setup_inputs(seed: int = 0) -> dict:
    key = jax.random.key(seed)
    ks = iter(jax.random.split(key, 40))

    def nrm(shape, scale):
        return jax.random.normal(next(ks), shape, jnp.float32) * scale

    def gain(shape):
        return 1.0 + nrm(shape, 0.02)

    return {
        'x_prompt': nrm((BATCH, SEQ, D_MODEL), 1.0),
        'x_sample': nrm((DEC_BATCH, DEC_SEQ, D_MODEL), 1.0),
        'mem_prompt': nrm((BATCH, N_MEM, D_MODEL), 1.0),
        'state_conv': nrm((DEPTH, DEC_BATCH, CONV_BUF, D_CONV), 0.5),
        'state_hgrn': nrm((DEPTH, DEC_BATCH, HGRN_HEADS, HGRN_DK, HGRN_DV), 0.5),
        'cache_mem_k': nrm((DEPTH, DEC_BATCH, N_MEM, MEM_HEADS, MEM_HEAD_DIM), 1.0),
        'cache_mem_v': nrm((DEPTH, DEC_BATCH, N_MEM, MEM_HEADS, MEM_HEAD_DIM), 1.0),
        'ffn1_norm': gain((DEPTH, D_MODEL)),
        'ffn1_w_gate': nrm((DEPTH, D_MODEL, D_FF), D_MODEL ** -0.5),
        'ffn1_w_up': nrm((DEPTH, D_MODEL, D_FF), D_MODEL ** -0.5),
        'ffn1_w_down': nrm((DEPTH, D_FF, D_MODEL), D_FF ** -0.5),
        'mix_norm': gain((DEPTH, D_MODEL)),
        'w_in': nrm((DEPTH, D_MODEL, D_IN), D_MODEL ** -0.5),
        'conv_dw': nrm((DEPTH, CONV_WIDTH, D_CONV), CONV_WIDTH ** -0.5),
        'conv_dw_b': nrm((DEPTH, D_CONV), 0.02),
        'conv_ln_g': gain((DEPTH, D_CONV)),
        'conv_ln_b': nrm((DEPTH, D_CONV), 0.02),
        'hgrn_lb': nrm((DEPTH + 1, D_HGRN), 0.1),
        'hgrn_norm': gain((DEPTH, HGRN_HEADS, HGRN_DV)),
        'w_out': nrm((DEPTH, D_MIX, D_MODEL), D_MIX ** -0.5),
        'mem_norm': gain((DEPTH, D_MODEL)),
        'mem_wk': nrm((DEPTH, D_MODEL, D_MODEL), D_MODEL ** -0.5),
        'mem_wv': nrm((DEPTH, D_MODEL, D_MODEL), D_MODEL ** -0.5),
        'xattn_norm': gain((DEPTH, D_MODEL)),
        'xattn_wq': nrm((DEPTH, D_MODEL, D_MODEL), D_MODEL ** -0.5),
        'xattn_wo': nrm((DEPTH, D_MODEL, D_MODEL), D_MODEL ** -0.5),
        'ffn2_norm': gain((DEPTH, D_MODEL)),
        'ffn2_w_gate': nrm((DEPTH, D_MODEL, D_FF), D_MODEL ** -0.5),
        'ffn2_w_up': nrm((DEPTH, D_MODEL, D_FF), D_MODEL ** -0.5),
        'ffn2_w_down': nrm((DEPTH, D_FF, D_MODEL), D_FF ** -0.5),
        'final_norm': gain((D_MODEL,)),
    }


def reference(x_prompt, x_sample, mem_prompt, state_conv, state_hgrn, cache_mem_k, cache_mem_v,
              ffn1_norm, ffn1_w_gate, ffn1_w_up, ffn1_w_down, mix_norm, w_in, conv_dw, conv_dw_b,
              conv_ln_g, conv_ln_b, hgrn_lb, hgrn_norm, w_out, mem_norm, mem_wk, mem_wv,
              xattn_norm, xattn_wq, xattn_wo, ffn2_norm, ffn2_w_gate, ffn2_w_up, ffn2_w_down,
              final_norm):
    lb_all = jnp.cumsum(jax.nn.softmax(hgrn_lb.astype(jnp.float32), axis=0), axis=0)
    bp = x_prompt.shape[0]
    xp, xs = x_prompt, x_sample
    conv_p, hgrn_p, mk_p, mv_p, conv_s, hgrn_s = [], [], [], [], [], []
    for l in range(DEPTH):
        w = {
            'ffn1_norm': ffn1_norm[l], 'ffn1_w_gate': ffn1_w_gate[l], 'ffn1_w_up': ffn1_w_up[l],
            'ffn1_w_down': ffn1_w_down[l], 'mix_norm': mix_norm[l], 'w_in': w_in[l],
            'conv_dw': conv_dw[l], 'conv_dw_b': conv_dw_b[l], 'conv_ln_g': conv_ln_g[l],
            'conv_ln_b': conv_ln_b[l], 'hgrn_norm': hgrn_norm[l], 'w_out': w_out[l],
            'xattn_norm': xattn_norm[l], 'xattn_wq': xattn_wq[l], 'xattn_wo': xattn_wo[l],
            'ffn2_norm': ffn2_norm[l], 'ffn2_w_gate': ffn2_w_gate[l], 'ffn2_w_up': ffn2_w_up[l],
            'ffn2_w_down': ffn2_w_down[l],
        }
        mk, mv = mem_kv(mem_prompt, mem_norm[l], mem_wk[l], mem_wv[l])
        buf0 = jnp.zeros((bp, CONV_BUF, D_CONV), xp.dtype)
        s0 = jnp.zeros((bp, HGRN_HEADS, HGRN_DK, HGRN_DV), jnp.float32)
        xp, buf_p, s_p = encoder_layer(xp, buf0, s0, mk, mv, lb_all[l], w)
        xs, buf_s, s_s = encoder_layer(xs, state_conv[l], state_hgrn[l], cache_mem_k[l],
                                       cache_mem_v[l], lb_all[l], w)
        conv_p.append(buf_p)
        hgrn_p.append(s_p.astype(x_prompt.dtype))
        mk_p.append(mk)
        mv_p.append(mv)
        conv_s.append(buf_s.astype(state_conv.dtype))
        hgrn_s.append(s_s.astype(state_hgrn.dtype))
    y_prompt = rms_norm(xp, final_norm)
    y_sample = rms_norm(xs, final_norm)
    return (y_prompt, y_sample, jnp.stack(conv_p), jnp.stack(hgrn_p), jnp.stack(mk_p),
            jnp.stack(mv_p), jnp.stack(conv_s), jnp.stack(hgrn_s))
```

```cpp
#include <hip/hip_runtime.h>
#include <hip/hip_cooperative_groups.h>
#include <cstdio>
namespace cg = cooperative_groups;

#ifndef MK_MULTI
#define MK_MULTI 0
#endif

#ifndef MK_NPH
#define MK_NPH 14
#endif
#define LAS __attribute__((address_space(3)))
typedef unsigned short bf16_t;
typedef short bf16x8 __attribute__((ext_vector_type(8)));
typedef float f32x4 __attribute__((ext_vector_type(4)));
typedef unsigned u32x4 __attribute__((ext_vector_type(4)));
typedef unsigned u32x2 __attribute__((ext_vector_type(2)));

constexpr int D = 1024, MP = 16384, MS = 512, M = MP + MS, FF = 2816, NMEM = 256;
constexpr int SEQ = 2048, DSEQ = 32, NB = 8, NDB = 16;
constexpr float EPS = 1e-6f;
constexpr int NTHREADS = 512, NWAVES = 8;
constexpr int LDS_BYTES = 147456;

constexpr size_t O_Y = 0;
constexpr size_t O_CONVP = (size_t)M * D;
constexpr size_t O_HGRNP = O_CONVP + (size_t)NB * 30 * 512;
constexpr size_t O_MK = O_HGRNP + (size_t)NB * 4 * 128 * 128;
constexpr size_t O_MV = O_MK + (size_t)NB * NMEM * D;
constexpr size_t O_CONVS = O_MV + (size_t)NB * NMEM * D;
constexpr size_t O_HGRNS = O_CONVS + (size_t)NDB * 30 * 512;

constexpr size_t WS_WGU1 = 0;
constexpr size_t WS_WD1 = WS_WGU1 + (size_t)2 * FF * D * 2;
constexpr size_t WS_WIN = WS_WD1 + (size_t)D * FF * 2;
constexpr size_t WS_WOUT = WS_WIN + (size_t)3072 * D * 2;
constexpr size_t WS_WKV = WS_WOUT + (size_t)D * D * 2;
constexpr size_t WS_WQ = WS_WKV + (size_t)2 * D * D * 2;
constexpr size_t WS_WO = WS_WQ + (size_t)D * D * 2;
constexpr size_t WS_WGU2 = WS_WO + (size_t)D * D * 2;
constexpr size_t WS_WD2 = WS_WGU2 + (size_t)2 * FF * D * 2;
constexpr size_t WS_B0 = WS_WD2 + (size_t)D * FF * 2;
constexpr size_t WS_HZ = WS_B0 + (size_t)M * D * 2;
constexpr size_t ZSZ = (size_t)M * 512 * 2;
constexpr size_t WS_U = WS_HZ, WS_QD = WS_HZ + ZSZ, WS_KD = WS_HZ + 2 * ZSZ, WS_V = WS_HZ + 3 * ZSZ, WS_SG = WS_HZ + 4 * ZSZ;
constexpr size_t WS_KV = WS_HZ + (size_t)M * FF * 2;
constexpr size_t WS_B1 = WS_KV;
constexpr size_t WS_MB = WS_KV + (size_t)1024 * 65536;
constexpr size_t WS_RSTD0 = WS_MB + (size_t)2048 * D * 2;
constexpr size_t WS_RSTDM = WS_RSTD0 + (size_t)M * 4;
constexpr size_t WS_SSQ1 = WS_RSTDM + 2048 * 4;
constexpr size_t WS_SSQ2 = WS_SSQ1 + (size_t)M * 64;
constexpr size_t WS_SSQ3 = WS_SSQ2 + (size_t)M * 64;
constexpr size_t WS_GL = WS_SSQ3 + (size_t)M * 64;
constexpr size_t WS_LB = WS_GL + (size_t)272 * 512 * 4;
constexpr size_t WS_END0 = WS_LB + 512 * 4;
constexpr size_t WS_KB = WS_KV + (size_t)36 * 1048576;
constexpr size_t WS_VTP = WS_KB + (size_t)6144 * D * 2;
constexpr size_t WS_VTS = WS_VTP + (size_t)D * 2048 * 2;
constexpr size_t WS_END = WS_END0;
static_assert(WS_VTS + (size_t)16 * D * 256 * 2 <= WS_MB && WS_B1 + (size_t)M * D * 2 <= WS_KB, "attention K/V^T copies fit behind B1 inside the KV region");
static_assert(WS_END <= 268435456, "d_ws map");
static_assert(5 * ZSZ <= (size_t)M * FF * 2, "z tensors fit the H region");

__device__ __forceinline__ unsigned cvt_pk_bf16(float lo, float hi) { unsigned r; asm volatile("v_cvt_pk_bf16_f32 %0, %1, %2" : "=v"(r) : "v"(lo), "v"(hi)); return r; }
__device__ __forceinline__ float bf2f(bf16_t b) { return __uint_as_float(((unsigned)b) << 16); }
__device__ __forceinline__ float fsigmoid(float x) { return __builtin_amdgcn_rcpf(1.f + __expf(-x)); }
__device__ __forceinline__ float fsilu(float x) { return x * fsigmoid(x); }
__device__ __forceinline__ float wave_sum(float v) {
#pragma unroll
    for (int o = 1; o < 64; o <<= 1) v += __shfl_xor(v, o);
    return v;
}
__device__ __forceinline__ float rstd_from_parts(const float* ssq, int r) {
    const f32x4* p = (const f32x4*)(ssq + (size_t)r * 16);
    const f32x4 a = p[0], b = p[1], c = p[2], d = p[3];
    const float s = ((a[0] + a[1]) + (a[2] + a[3])) + ((b[0] + b[1]) + (b[2] + b[3])) + ((c[0] + c[1]) + (c[2] + c[3])) + ((d[0] + d[1]) + (d[2] + d[3]));
    return rsqrtf(s * (1.f / 1024.f) + EPS);
}

namespace pg8 {
constexpr int BM = 256, BK = 64, HALF = 128, HTB = HALF * BK * 2, STAGE_BYTES = 8 * HTB, NXCD = 8, WGM = 8;
__device__ __forceinline__ int lds_byte(int r, int c) { const int st = (r >> 4) * 2 + (c >> 5), rr = r & 15, cc = c & 31, ob = rr * 64 + cc * 2; return st * 1024 + (ob ^ (((ob >> 9) & 1) << 5)); }
__device__ __forceinline__ void stage_rc(int b, int& R, int& C) { const int st = b / 1024, sb = b % 1024, swz = sb ^ (((sb >> 9) & 1) << 5); R = (st >> 1) * 16 + swz / 64; C = (st & 1) * 32 + (swz % 64) / 2; }
__device__ __forceinline__ int perm32(int rho) { const int n = rho >> 4, i = rho & 15; return 8 * (i >> 2) + 4 * n + (i & 3); }

struct Unit { int pm, pn; };
struct Gemm { const bf16_t* A; const bf16_t* Bt; int M, N, K; };

struct StaticOrder {
    int nM, nN, nwg, G, c;
    __device__ void init(int M_, int N_, int G_, int c_) { nM = M_ / BM; nN = N_ / BM; nwg = nM * nN; G = G_; c = c_; }
    __device__ bool next(int i, Unit& u) const {
        const long L = (long)i * G + c; if (L >= nwg) return false;
        int wgid = (int)L; { const int q = nwg / NXCD, r = nwg % NXCD, xcd = wgid % NXCD, off = wgid / NXCD; wgid = (xcd < r ? xcd * (q + 1) : r * (q + 1) + (xcd - r) * q) + off; }
        const int nig = WGM * nN, gid = wgid / nig, fm = gid * WGM, gsz = (nM - fm) < WGM ? (nM - fm) : WGM;
        u.pm = fm + ((wgid % nig) % gsz); u.pn = (wgid % nig) / gsz; return true;
    }
    __device__ __forceinline__ void a_ready(const Unit&) const {}
    __device__ __forceinline__ void done(const Unit&) const {}
};

template <class Epi, class Sched>
__device__ __forceinline__ void gemm_phase(LAS unsigned char* lds, const Gemm g, const Sched& S, const Epi& E) {
    const int tid = threadIdx.x, wid = __builtin_amdgcn_readfirstlane(tid >> 6), lane = tid & 63, wr = wid >> 2, wc = wid & 3, fr = lane & 15, fq = lane >> 4;
    const int K = g.K, nt = K / BK;
    unsigned voffA[2], voffB[2];
#pragma unroll
    for (int i = 0; i < 2; ++i) { int R, C; stage_rc(tid * 16 + i * 8192, R, C); const int Rb = Epi::PERM ? ((R & ~31) + perm32(R & 31)) : R;
        voffA[i] = (unsigned)(R * K + C) * 2u; voffB[i] = (unsigned)(Rb * K + C) * 2u; }
    const size_t kstep = (size_t)(BK * 2);
    const size_t hstep = (size_t)HALF * K * 2;
    const size_t tstep = 2 * hstep;
    const unsigned ldsw = (unsigned)wid * 1024u;
    const int aoff = lds_byte(wr * 64 + fr, fq * 8), boff = lds_byte(wc * 32 + fr, fq * 8);
#define PG8_SA(b, h) (((b) * 2 + (h)) * HTB)
#define PG8_SB(b, h) ((4 + (b) * 2 + (h)) * HTB)
#define PG8_STAGE(bufoff, gbase, voff) do { _Pragma("unroll") for (int _i = 0; _i < 2; ++_i) \
        __builtin_amdgcn_global_load_lds((const unsigned*)((const char*)(gbase) + (voff)[_i]), (LAS unsigned*)(lds + (bufoff) + ldsw + _i * 8192), 16, 0, 0); } while (0)
#define PG8_LDA(dst, b, h) do { _Pragma("unroll") for (int m = 0; m < 4; ++m) _Pragma("unroll") for (int k = 0; k < 2; ++k) dst[m][k] = *(const LAS bf16x8*)(lds + PG8_SA(b, h) + aoff + m * 2048 + k * 1024); } while (0)
#define PG8_LDB(dst, b, h) do { _Pragma("unroll") for (int n = 0; n < 2; ++n) _Pragma("unroll") for (int k = 0; k < 2; ++k) dst[n][k] = *(const LAS bf16x8*)(lds + PG8_SB(b, h) + boff + n * 2048 + k * 1024); } while (0)
#define PG8_MMA(ai, bj, At, Bt) do { __builtin_amdgcn_s_setprio(1); _Pragma("unroll") for (int m = 0; m < 4; ++m) _Pragma("unroll") for (int n = 0; n < 2; ++n) _Pragma("unroll") for (int k = 0; k < 2; ++k) \
        acc[ai][bj][m][n] = __builtin_amdgcn_mfma_f32_16x16x32_bf16(Bt[n][k], At[m][k], acc[ai][bj][m][n], 0, 0, 0); __builtin_amdgcn_s_setprio(0); } while (0)
#define PG8_WAIT_V(n) asm volatile("s_waitcnt vmcnt(" #n ")" ::: "memory")
#define PG8_WAIT_L(n) asm volatile("s_waitcnt lgkmcnt(" #n ")" ::: "memory")
#define PG8_BAR __builtin_amdgcn_s_barrier()
#define PG8_SCHED __builtin_amdgcn_sched_barrier(0)
    Unit cur, nxt; int ui = 0;
    if (!S.next(0, cur)) return;
    f32x4 acc[2][2][4][2];
#pragma unroll
    for (int a = 0; a < 2; ++a)
#pragma unroll
        for (int b = 0; b < 2; ++b)
#pragma unroll
            for (int m = 0; m < 4; ++m)
#pragma unroll
                for (int n = 0; n < 2; ++n) acc[a][b][m][n] = (f32x4){0.f, 0.f, 0.f, 0.f};
    bf16x8 At[4][2], B0[2][2], B1[2][2];
    const char* cA = (const char*)g.A + (size_t)cur.pm * tstep; const char* cB = (const char*)g.Bt + (size_t)cur.pn * tstep;
    S.a_ready(cur);
    PG8_STAGE(PG8_SB(0, 0), cB, voffB); PG8_STAGE(PG8_SA(0, 0), cA, voffA); PG8_STAGE(PG8_SB(0, 1), cB + hstep, voffB); PG8_STAGE(PG8_SA(0, 1), cA + hstep, voffA);
    if (wr == 1) PG8_BAR;
    PG8_WAIT_V(4); PG8_BAR;
    PG8_STAGE(PG8_SB(1, 0), cB + kstep, voffB); PG8_STAGE(PG8_SA(1, 0), cA + kstep, voffA); PG8_STAGE(PG8_SB(1, 1), cB + hstep + kstep, voffB);
    PG8_WAIT_V(6); PG8_BAR;
    for (;;) {
        const bool has_next = S.next(ui + 1, nxt);
        const char* nA = has_next ? (const char*)g.A + (size_t)nxt.pm * tstep : cA; const char* nB = has_next ? (const char*)g.Bt + (size_t)nxt.pn * tstep : cB;
        for (int t = 0; t < nt; t += 2) {
            const bool last = (t == nt - 2);
            const char* a1 = cA + (size_t)(t + 1) * kstep;
            const char* a2 = last ? nA : cA + (size_t)(t + 2) * kstep; const char* b2 = last ? nB : cB + (size_t)(t + 2) * kstep;
            const char* a3 = a2 + kstep; const char* b3 = b2 + kstep;
            if (last && has_next) S.a_ready(nxt);
            PG8_LDB(B0, 0, 0); PG8_SCHED; PG8_LDA(At, 0, 0); PG8_STAGE(PG8_SA(1, 1), a1 + hstep, voffA);
            PG8_WAIT_L(8); PG8_BAR; PG8_WAIT_L(0); PG8_MMA(0, 0, At, B0); PG8_BAR; PG8_SCHED;
            PG8_LDB(B1, 0, 1); PG8_STAGE(PG8_SB(0, 0), b2, voffB);
            PG8_BAR; PG8_WAIT_L(0); PG8_MMA(0, 1, At, B1); PG8_BAR;
            PG8_LDA(At, 0, 1); PG8_STAGE(PG8_SA(0, 0), a2, voffA);
            PG8_BAR; PG8_WAIT_L(0); PG8_MMA(1, 0, At, B0); PG8_BAR; PG8_SCHED;
            PG8_STAGE(PG8_SB(0, 1), b2 + hstep, voffB);
            PG8_WAIT_V(6); PG8_BAR; PG8_MMA(1, 1, At, B1); PG8_BAR;
            PG8_LDB(B0, 1, 0); PG8_SCHED; PG8_LDA(At, 1, 0); PG8_STAGE(PG8_SA(0, 1), a2 + hstep, voffA);
            PG8_WAIT_L(8); PG8_BAR; PG8_WAIT_L(0); PG8_MMA(0, 0, At, B0); PG8_BAR; PG8_SCHED;
            PG8_LDB(B1, 1, 1); PG8_STAGE(PG8_SB(1, 0), b3, voffB);
            PG8_BAR; PG8_WAIT_L(0); PG8_MMA(0, 1, At, B1); PG8_BAR;
            PG8_LDA(At, 1, 1); PG8_STAGE(PG8_SA(1, 0), a3, voffA);
            PG8_BAR; PG8_WAIT_L(0); PG8_MMA(1, 0, At, B0); PG8_BAR; PG8_SCHED;
            PG8_STAGE(PG8_SB(1, 1), b3 + hstep, voffB);
            PG8_WAIT_V(6); PG8_BAR; PG8_MMA(1, 1, At, B1); PG8_BAR;
        }
        E(acc, cur, wr, wc, fr, fq); S.done(cur);
        if (!has_next) break;
#pragma unroll
        for (int a = 0; a < 2; ++a)
#pragma unroll
            for (int b = 0; b < 2; ++b)
#pragma unroll
                for (int m = 0; m < 4; ++m)
#pragma unroll
                    for (int n = 0; n < 2; ++n) acc[a][b][m][n] = (f32x4){0.f, 0.f, 0.f, 0.f};
        cur = nxt; cA = nA; cB = nB; ++ui;
    }
    PG8_WAIT_V(0);
    if (wr == 0) PG8_BAR;
    PG8_BAR;
#undef PG8_SA
#undef PG8_SB
#undef PG8_STAGE
#undef PG8_LDA
#undef PG8_LDB
#undef PG8_MMA
#undef PG8_WAIT_V
#undef PG8_WAIT_L
#undef PG8_BAR
#undef PG8_SCHED
}
}
using pg8::Unit;
typedef f32x4 AccT[2][2][4][2];

struct EpiSwiGLU {
    static constexpr bool PERM = true;
    bf16_t* H; const float* rstd; const float* ssq;
    __device__ __forceinline__ void operator()(const AccT& acc, const Unit& u, int wr, int wc, int fr, int fq) const {
#pragma unroll
        for (int ai = 0; ai < 2; ++ai)
#pragma unroll
            for (int m = 0; m < 4; ++m) {
                const int r = u.pm * 256 + ai * 128 + wr * 64 + m * 16 + fr;
                const float rs = rstd ? rstd[r] : rstd_from_parts(ssq, r);
                float h[8];
#pragma unroll
                for (int n = 0; n < 2; ++n)
#pragma unroll
                    for (int j = 0; j < 4; ++j) h[n * 4 + j] = fsilu(acc[ai][0][m][n][j] * rs) * (acc[ai][1][m][n][j] * rs);
                u32x4 w; w.x = cvt_pk_bf16(h[0], h[1]); w.y = cvt_pk_bf16(h[2], h[3]); w.z = cvt_pk_bf16(h[4], h[5]); w.w = cvt_pk_bf16(h[6], h[7]);
                *(u32x4*)(H + (size_t)r * FF + u.pn * 128 + wc * 32 + 8 * fq) = w;
            }
    }
};
struct EpiResid {
    static constexpr bool PERM = false;
    const float* xin_p; const float* xin_s; float* X; bf16_t* XB; float* ssq; float scale;
    __device__ __forceinline__ void operator()(const AccT& acc, const Unit& u, int wr, int wc, int fr, int fq) const {
#pragma unroll
        for (int ai = 0; ai < 2; ++ai)
#pragma unroll
            for (int m = 0; m < 4; ++m) {
                const int r = u.pm * 256 + ai * 128 + wr * 64 + m * 16 + fr;
                const float* xi = (r < MP) ? xin_p + (size_t)r * D : xin_s + (size_t)(r - MP) * D;
                const int col0 = u.pn * 256 + wc * 32 + 4 * fq;
                float ss = 0.f;
#pragma unroll
                for (int bj = 0; bj < 2; ++bj)
#pragma unroll
                    for (int n = 0; n < 2; ++n) {
                        const int c = col0 + bj * 128 + n * 16;
                        const f32x4 v = *(const f32x4*)(xi + c) + acc[ai][bj][m][n] * scale;
                        *(f32x4*)(X + (size_t)r * D + c) = v;
                        if (XB) { u32x2 w; w.x = cvt_pk_bf16(v[0], v[1]); w.y = cvt_pk_bf16(v[2], v[3]); *(u32x2*)(XB + (size_t)r * D + c) = w; }
                        ss += (v[0] * v[0] + v[1] * v[1]) + (v[2] * v[2] + v[3] * v[3]);
                    }
                ss += __shfl_xor(ss, 16); ss += __shfl_xor(ss, 32);
                if (ssq && fq == 0) ssq[(size_t)r * 16 + u.pn * 4 + wc] = ss;
            }
    }
};
struct EpiScaleBf16 {
    static constexpr bool PERM = true;
    bf16_t* O; const float* ssq;
    __device__ __forceinline__ void operator()(const AccT& acc, const Unit& u, int wr, int wc, int fr, int fq) const {
#pragma unroll
        for (int ai = 0; ai < 2; ++ai)
#pragma unroll
            for (int m = 0; m < 4; ++m) {
                const int r = u.pm * 256 + ai * 128 + wr * 64 + m * 16 + fr;
                const float rs = rstd_from_parts(ssq, r);
#pragma unroll
                for (int bj = 0; bj < 2; ++bj) {
                    const f32x4 a = acc[ai][bj][m][0] * rs, b = acc[ai][bj][m][1] * rs;
                    u32x4 w; w.x = cvt_pk_bf16(a[0], a[1]); w.y = cvt_pk_bf16(a[2], a[3]); w.z = cvt_pk_bf16(b[0], b[1]); w.w = cvt_pk_bf16(b[2], b[3]);
                    *(u32x4*)(O + (size_t)r * D + u.pn * 256 + bj * 128 + wc * 32 + 8 * fq) = w;
                }
            }
    }
};
struct EpiMemKV {
    static constexpr bool PERM = false;
    float* mk; float* mv; const float* rstd; bf16_t* KB;
    __device__ __forceinline__ void operator()(const AccT& acc, const Unit& u, int wr, int wc, int fr, int fq) const {
        float* base = (u.pn < 4) ? mk : mv;
#pragma unroll
        for (int ai = 0; ai < 2; ++ai)
#pragma unroll
            for (int m = 0; m < 4; ++m) {
                const int r = u.pm * 256 + ai * 128 + wr * 64 + m * 16 + fr;
                const float rs = rstd[r];
#pragma unroll
                for (int bj = 0; bj < 2; ++bj)
#pragma unroll
                    for (int n = 0; n < 2; ++n) {
                        const int c = (u.pn & 3) * 256 + bj * 128 + wc * 32 + n * 16 + 4 * fq;
                        const f32x4 v = acc[ai][bj][m][n] * rs;
                        *(f32x4*)(base + (size_t)r * D + c) = v;
                        if (u.pn < 4) { u32x2 w; w.x = cvt_pk_bf16(v[0], v[1]); w.y = cvt_pk_bf16(v[2], v[3]); *(u32x2*)(KB + (size_t)r * D + c) = w; }
                    }
            }
    }
};
struct EpiVT {
    static constexpr bool PERM = true;
    bf16_t* VT; const float* rstd;
    __device__ __forceinline__ void operator()(const AccT& acc, const Unit& u, int wr, int wc, int fr, int fq) const {
#pragma unroll
        for (int bj = 0; bj < 2; ++bj) {
            const int c = u.pn * 256 + bj * 128 + wc * 32 + 8 * fq;
            const f32x4 s0 = *(const f32x4*)(rstd + c), s1 = *(const f32x4*)(rstd + c + 4);
#pragma unroll
            for (int ai = 0; ai < 2; ++ai)
#pragma unroll
                for (int m = 0; m < 4; ++m) {
                    const int r = u.pm * 256 + ai * 128 + wr * 64 + m * 16 + fr;
                    const f32x4 a = acc[ai][bj][m][0] * s0, b = acc[ai][bj][m][1] * s1;
                    u32x4 w; w.x = cvt_pk_bf16(a[0], a[1]); w.y = cvt_pk_bf16(a[2], a[3]); w.z = cvt_pk_bf16(b[0], b[1]); w.w = cvt_pk_bf16(b[2], b[3]);
                    *(u32x4*)(VT + (size_t)r * 2048 + c) = w;
                }
        }
    }
};
struct EpiWin {
    static constexpr bool PERM = true;
    const float* ssq; const float* LB;
    bf16_t *U, *QD, *KD, *V, *SG; float* GL; float* convp; float* convs;
    __device__ __forceinline__ void operator()(const AccT& acc, const Unit& u, int wr, int wc, int fr, int fq) const {
        const int cb = wc * 32 + 8 * fq;
        const bool sample = (u.pm >= 64);
        if (u.pn < 4) {
#pragma unroll
            for (int ai = 0; ai < 2; ++ai)
#pragma unroll
                for (int m = 0; m < 4; ++m) {
                    const int r = u.pm * 256 + ai * 128 + wr * 64 + m * 16 + fr;
                    const float rs = rstd_from_parts(ssq, r);
                    float o[8];
#pragma unroll
                    for (int n = 0; n < 2; ++n)
#pragma unroll
                        for (int j = 0; j < 4; ++j) o[n * 4 + j] = (acc[ai][0][m][n][j] * rs) * fsigmoid(acc[ai][1][m][n][j] * rs);
                    u32x4 w; w.x = cvt_pk_bf16(o[0], o[1]); w.y = cvt_pk_bf16(o[2], o[3]); w.z = cvt_pk_bf16(o[4], o[5]); w.w = cvt_pk_bf16(o[6], o[7]);
                    const int c = u.pn * 128 + cb;
                    *(u32x4*)(U + (size_t)r * 512 + c) = w;
                    float* dst = nullptr;
                    if (!sample) { const int b = r >> 11, t = r & 2047; if (t >= SEQ - 30) dst = convp + ((size_t)(b * 30 + t - (SEQ - 30))) * 512 + c; }
                    else { const int rr = r - MP, b = rr >> 5, t = rr & 31; if (t >= 2) dst = convs + ((size_t)(b * 30 + t - 2)) * 512 + c; }
                    if (dst) { *(f32x4*)dst = (f32x4){o[0], o[1], o[2], o[3]}; *(f32x4*)(dst + 4) = (f32x4){o[4], o[5], o[6], o[7]}; }
                }
        } else if ((u.pn & 1) == 0) {
            const int h = (u.pn - 4) >> 1;
#pragma unroll
            for (int ai = 0; ai < 2; ++ai) {
                float rs[4];
#pragma unroll
                for (int m = 0; m < 4; ++m) rs[m] = rstd_from_parts(ssq, u.pm * 256 + ai * 128 + wr * 64 + m * 16 + fr);
                unsigned oq[4][4], ok[4][4];
                float glA[8], glB[8];
#pragma unroll
                for (int n = 0; n < 2; ++n)
#pragma unroll
                    for (int jp = 0; jp < 2; ++jp) {
                        float qv[2][4], kv[2][4];
#pragma unroll
                        for (int jj = 0; jj < 2; ++jj) {
                            const int j = jp * 2 + jj;
                            const float lbv = LB[h * 128 + cb + n * 4 + j];
                            float carry = 0.f;
#pragma unroll
                            for (int m = 0; m < 4; ++m) {
                                if (sample && m == 2) carry = 0.f;
                                const float zq = acc[ai][0][m][n][j] * rs[m], zf = acc[ai][1][m][n][j] * rs[m];
                                const float kk = (1.f - lbv) * fsigmoid(-zf);
                                float x = __logf(1.f - kk);
#pragma unroll
                                for (int d = 1; d < 16; d <<= 1) { const float y = __shfl_up(x, d, 16); if (fr >= d) x += y; }
                                x += carry; carry = __shfl(x, 15, 16);
                                const float e = __expf(x);
                                qv[jj][m] = fsilu(zq) * e; kv[jj][m] = kk * __expf(-x);
                                if (m == 1) glA[n * 4 + j] = carry;
                            }
                            glB[n * 4 + j] = carry;
                        }
#pragma unroll
                        for (int m = 0; m < 4; ++m) { oq[m][n * 2 + jp] = cvt_pk_bf16(qv[0][m], qv[1][m]); ok[m][n * 2 + jp] = cvt_pk_bf16(kv[0][m], kv[1][m]); }
                    }
#pragma unroll
                for (int m = 0; m < 4; ++m) {
                    const int r = u.pm * 256 + ai * 128 + wr * 64 + m * 16 + fr;
                    *(u32x4*)(QD + (size_t)r * 512 + h * 128 + cb) = (u32x4){oq[m][0], oq[m][1], oq[m][2], oq[m][3]};
                    *(u32x4*)(KD + (size_t)r * 512 + h * 128 + cb) = (u32x4){ok[m][0], ok[m][1], ok[m][2], ok[m][3]};
                }
                if (fr == 0) {
                    if (!sample) {
                        float* g = GL + (size_t)(u.pm * 4 + ai * 2 + wr) * 512 + h * 128 + cb;
                        *(f32x4*)g = (f32x4){glB[0], glB[1], glB[2], glB[3]}; *(f32x4*)(g + 4) = (f32x4){glB[4], glB[5], glB[6], glB[7]};
                    } else {
                        float* g = GL + (size_t)(256 + (u.pm - 64) * 8 + ai * 4 + wr * 2) * 512 + h * 128 + cb;
                        *(f32x4*)g = (f32x4){glA[0], glA[1], glA[2], glA[3]}; *(f32x4*)(g + 4) = (f32x4){glA[4], glA[5], glA[6], glA[7]};
                        *(f32x4*)(g + 512) = (f32x4){glB[0], glB[1], glB[2], glB[3]}; *(f32x4*)(g + 516) = (f32x4){glB[4], glB[5], glB[6], glB[7]};
                    }
                }
            }
        } else {
            const int h = (u.pn - 5) >> 1;
#pragma unroll
            for (int ai = 0; ai < 2; ++ai)
#pragma unroll
                for (int m = 0; m < 4; ++m) {
                    const int r = u.pm * 256 + ai * 128 + wr * 64 + m * 16 + fr;
                    const float rs = rstd_from_parts(ssq, r);
                    const f32x4 a = acc[ai][0][m][0] * rs, b = acc[ai][0][m][1] * rs, c = acc[ai][1][m][0] * rs, d = acc[ai][1][m][1] * rs;
                    u32x4 w; w.x = cvt_pk_bf16(a[0], a[1]); w.y = cvt_pk_bf16(a[2], a[3]); w.z = cvt_pk_bf16(b[0], b[1]); w.w = cvt_pk_bf16(b[2], b[3]);
                    *(u32x4*)(V + (size_t)r * 512 + h * 128 + cb) = w;
                    u32x4 s; s.x = cvt_pk_bf16(fsilu(c[0]), fsilu(c[1])); s.y = cvt_pk_bf16(fsilu(c[2]), fsilu(c[3])); s.z = cvt_pk_bf16(fsilu(d[0]), fsilu(d[1])); s.w = cvt_pk_bf16(fsilu(d[2]), fsilu(d[3]));
                    *(u32x4*)(SG + (size_t)r * 512 + h * 128 + cb) = s;
                }
        }
    }
};

struct Params { const float* in[31]; float* out; unsigned char* ws; int ph_lo, ph_hi; };
enum { I_XP = 0, I_XS, I_MEM, I_SCONV, I_SHGRN, I_CK, I_CV, I_F1N, I_F1G, I_F1U, I_F1D, I_MIXN, I_WIN, I_CDW, I_CDWB, I_CLNG, I_CLNB, I_HLB, I_HNORM, I_WOUT,
       I_MEMN, I_WK, I_WV, I_XAN, I_WQ, I_WO, I_F2N, I_F2G, I_F2U, I_F2D, I_FINN };

__device__ __forceinline__ int map_row(int type, int n0) {
    if (type == 0) return n0;
    if (type == 1) return 256 * (n0 >> 7) + (n0 & 127);
    if (type == 2) return 256 * (n0 >> 7) + 128 + (n0 & 127);
    const int grp = n0 >> 9, w = n0 & 511, blk = w >> 7, i = w & 127;
    const int unit = grp < 2 ? blk : (grp < 4 ? 4 + 2 * blk : 5 + 2 * blk);
    return 256 * unit + 128 * (grp & 1) + i;
}
__device__ __forceinline__ void p0_transpose_item(const float* W, int K, int N, bf16_t* WT, int type, int row_off, const float* gain, float scale, LAS float* scr, int item, int lane) {
    const int nblk = N / 32, kb = item / nblk, nb = item % nblk, k0 = 64 * kb, n0 = 32 * nb;
#pragma unroll 8
    for (int i = 0; i < 32; ++i) { const int kk = 2 * i + (lane >> 5); const float gsc = gain ? gain[k0 + kk] * scale : scale;
        scr[kk * 33 + (lane & 31)] = W[(size_t)(k0 + kk) * N + n0 + (lane & 31)] * gsc; }
    asm volatile("s_waitcnt lgkmcnt(0)" ::: "memory");
    const int c = lane & 7; const int r0 = row_off + map_row(type, n0);
#pragma unroll
    for (int j = 0; j < 4; ++j) { const int n = (lane >> 3) + 8 * j; const LAS float* s = scr + (8 * c) * 33 + n;
        u32x4 o; o.x = cvt_pk_bf16(s[0 * 33], s[1 * 33]); o.y = cvt_pk_bf16(s[2 * 33], s[3 * 33]); o.z = cvt_pk_bf16(s[4 * 33], s[5 * 33]); o.w = cvt_pk_bf16(s[6 * 33], s[7 * 33]);
        *(u32x4*)(WT + (size_t)(r0 + n) * K + k0 + 8 * c) = o; }
    asm volatile("s_waitcnt lgkmcnt(0)" ::: "memory");
}
__device__ __forceinline__ void row_to_bf16(const float* xrow, bf16_t* orow, float* rstd_out, int lane) {
    const f32x4* xr = (const f32x4*)xrow + lane;
    f32x4 v[4]; float s = 0.f;
#pragma unroll
    for (int j = 0; j < 4; ++j) { v[j] = xr[64 * j]; s += (v[j][0] * v[j][0] + v[j][1] * v[j][1]) + (v[j][2] * v[j][2] + v[j][3] * v[j][3]); }
    s = wave_sum(s);
    if (lane == 0) *rstd_out = rsqrtf(s * (1.f / 1024.f) + EPS);
    u32x2* o = (u32x2*)orow + lane;
#pragma unroll
    for (int j = 0; j < 4; ++j) { u32x2 w; w.x = cvt_pk_bf16(v[j][0], v[j][1]); w.y = cvt_pk_bf16(v[j][2], v[j][3]); o[64 * j] = w; }
}
__device__ __forceinline__ void phase_prologue(const Params& p, LAS unsigned char* lds) {
    unsigned char* ws = p.ws;
    const int lane = threadIdx.x & 63, wave = threadIdx.x >> 6;
    LAS float* scr = (LAS float*)(lds + wave * 16384);
    const int gw = blockIdx.x * NWAVES + wave, NGW = gridDim.x * NWAVES;
    constexpr int I_GU = (D / 64) * (FF / 32), I_DN = (FF / 64) * (D / 32), I_IN = (D / 64) * (3072 / 32), I_SQ = (D / 64) * (D / 32);
    constexpr int NITEMS = 4 * I_GU + 2 * I_DN + I_IN + 5 * I_SQ;
    for (int it = gw; it < NITEMS; it += NGW) {
        int r = it;
        if (r < I_GU) { p0_transpose_item(p.in[I_F1G], D, FF, (bf16_t*)(ws + WS_WGU1), 1, 0, p.in[I_F1N], 1.f, scr, r, lane); continue; } r -= I_GU;
        if (r < I_GU) { p0_transpose_item(p.in[I_F1U], D, FF, (bf16_t*)(ws + WS_WGU1), 2, 0, p.in[I_F1N], 1.f, scr, r, lane); continue; } r -= I_GU;
        if (r < I_GU) { p0_transpose_item(p.in[I_F2G], D, FF, (bf16_t*)(ws + WS_WGU2), 1, 0, p.in[I_F2N], 1.f, scr, r, lane); continue; } r -= I_GU;
        if (r < I_GU) { p0_transpose_item(p.in[I_F2U], D, FF, (bf16_t*)(ws + WS_WGU2), 2, 0, p.in[I_F2N], 1.f, scr, r, lane); continue; } r -= I_GU;
        if (r < I_DN) { p0_transpose_item(p.in[I_F1D], FF, D, (bf16_t*)(ws + WS_WD1), 0, 0, nullptr, 1.f, scr, r, lane); continue; } r -= I_DN;
        if (r < I_DN) { p0_transpose_item(p.in[I_F2D], FF, D, (bf16_t*)(ws + WS_WD2), 0, 0, nullptr, 1.f, scr, r, lane); continue; } r -= I_DN;
        if (r < I_IN) { p0_transpose_item(p.in[I_WIN], D, 3072, (bf16_t*)(ws + WS_WIN), 3, 0, p.in[I_MIXN], 1.f, scr, r, lane); continue; } r -= I_IN;
        if (r < I_SQ) { p0_transpose_item(p.in[I_WOUT], D, D, (bf16_t*)(ws + WS_WOUT), 0, 0, nullptr, 1.f, scr, r, lane); continue; } r -= I_SQ;
        if (r < I_SQ) { p0_transpose_item(p.in[I_WK], D, D, (bf16_t*)(ws + WS_WKV), 0, 0, p.in[I_MEMN], 1.f, scr, r, lane); continue; } r -= I_SQ;
        if (r < I_SQ) { p0_transpose_item(p.in[I_WV], D, D, (bf16_t*)(ws + WS_WKV), 0, 1024, p.in[I_MEMN], 1.f, scr, r, lane); continue; } r -= I_SQ;
        if (r < I_SQ) { p0_transpose_item(p.in[I_WQ], D, D, (bf16_t*)(ws + WS_WQ), 0, 0, p.in[I_XAN], 0.0625f, scr, r, lane); continue; } r -= I_SQ;
        p0_transpose_item(p.in[I_WO], D, D, (bf16_t*)(ws + WS_WO), 0, 0, nullptr, 1.f, scr, r, lane);
    }
    bf16_t* B0 = (bf16_t*)(ws + WS_B0); float* rstd0 = (float*)(ws + WS_RSTD0);
    for (int m = gw; m < M; m += NGW) {
        const float* src = (m < MP) ? p.in[I_XP] + (size_t)m * D : p.in[I_XS] + (size_t)(m - MP) * D;
        row_to_bf16(src, B0 + (size_t)m * D, rstd0 + m, lane);
    }
    bf16_t* MB = (bf16_t*)(ws + WS_MB); float* rstdm = (float*)(ws + WS_RSTDM);
    for (int m = gw; m < 2048; m += NGW) row_to_bf16(p.in[I_MEM] + (size_t)m * D, MB + (size_t)m * D, rstdm + m, lane);
    if (blockIdx.x == 0) { float* LB = (float*)(ws + WS_LB); const float* a = p.in[I_HLB]; LB[threadIdx.x] = 1.f / (1.f + expf(a[512 + threadIdx.x] - a[threadIdx.x])); }
}

__device__ __forceinline__ void sample_kv_convert(const Params& p, LAS unsigned char* lds) {
    unsigned char* ws = p.ws;
    const int lane = threadIdx.x & 63, wave = threadIdx.x >> 6;
    LAS float* scr = (LAS float*)(lds + wave * 16384);
    const int gw = blockIdx.x * NWAVES + wave, NGW = gridDim.x * NWAVES;
    bf16_t* KB = (bf16_t*)(ws + WS_KB) + (size_t)2048 * D;
    for (int m = gw; m < 4096; m += NGW) {
        const f32x4* xr = (const f32x4*)(p.in[I_CK] + (size_t)m * D) + lane; u32x2* o = (u32x2*)(KB + (size_t)m * D) + lane;
#pragma unroll
        for (int j = 0; j < 4; ++j) { const f32x4 v = xr[64 * j]; u32x2 w; w.x = cvt_pk_bf16(v[0], v[1]); w.y = cvt_pk_bf16(v[2], v[3]); o[64 * j] = w; }
    }
    constexpr int I_VT = (256 / 64) * (D / 32);
    for (int it = gw; it < 16 * I_VT; it += NGW) { const int b = it / I_VT, r = it % I_VT;
        p0_transpose_item(p.in[I_CV] + (size_t)b * 256 * D, 256, D, (bf16_t*)(ws + WS_VTS) + (size_t)b * D * 256, 0, 0, nullptr, 1.f, scr, r, lane); }
    __syncthreads();
}

__device__ __forceinline__ void conv_item(const Params& p, LAS unsigned char* lds, int item) {
    unsigned char* ws = p.ws;
    const bf16_t* U = (const bf16_t*)(ws + WS_U); bf16_t* MIX = (bf16_t*)(ws + WS_B0);
    LAS bf16_t* us = (LAS bf16_t*)lds;
    LAS float* ys = (LAS float*)(lds + 62 * 512 * 2);
    const int tid = threadIdx.x, lane = tid & 63, wave = tid >> 6;
    int rowbase, t0; const float* sbuf = nullptr;
    if (item < 512) { const int b = item >> 6; t0 = (item & 63) * 32; rowbase = b * SEQ; }
    else { const int b = item - 512; t0 = 0; rowbase = MP + b * DSEQ; sbuf = p.in[I_SCONV] + (size_t)b * 30 * 512; }
    for (int idx = tid; idx < 62 * 64; idx += NTHREADS) {
        const int i = idx >> 6, ch = idx & 63, t = t0 - 30 + i;
        u32x4 v = (u32x4){0u, 0u, 0u, 0u};
        if (t >= 0) v = *(const u32x4*)(U + (size_t)(rowbase + t) * 512 + ch * 8);
        else if (sbuf) { const f32x4 a = *(const f32x4*)(sbuf + (size_t)i * 512 + ch * 8), b = *(const f32x4*)(sbuf + (size_t)i * 512 + ch * 8 + 4);
            v.x = cvt_pk_bf16(a[0], a[1]); v.y = cvt_pk_bf16(a[2], a[3]); v.z = cvt_pk_bf16(b[0], b[1]); v.w = cvt_pk_bf16(b[2], b[3]); }
        *(LAS u32x4*)(us + i * 512 + ch * 8) = v;
    }
    float w[31];
#pragma unroll
    for (int j = 0; j < 31; ++j) w[j] = p.in[I_CDW][j * 512 + tid];
    const float bias = p.in[I_CDWB][tid];
    __syncthreads();
    for (int t = 0; t < 32; ++t) {
        float a = bias;
#pragma unroll
        for (int j = 0; j < 31; ++j) a += w[j] * bf2f(us[(t + j) * 512 + tid]);
        ys[t * 512 + tid] = a;
    }
    __syncthreads();
    const f32x4 g0 = *(const f32x4*)(p.in[I_CLNG] + lane * 8), g1 = *(const f32x4*)(p.in[I_CLNG] + lane * 8 + 4);
    const f32x4 b0 = *(const f32x4*)(p.in[I_CLNB] + lane * 8), b1 = *(const f32x4*)(p.in[I_CLNB] + lane * 8 + 4);
#pragma unroll
    for (int q = 0; q < 4; ++q) {
        const int t = wave * 4 + q;
        const f32x4 y0 = *(const LAS f32x4*)(ys + t * 512 + lane * 8), y1 = *(const LAS f32x4*)(ys + t * 512 + lane * 8 + 4);
        const float mu = wave_sum((y0[0] + y0[1]) + (y0[2] + y0[3]) + (y1[0] + y1[1]) + (y1[2] + y1[3])) * (1.f / 512.f);
        const f32x4 d0 = y0 - mu, d1 = y1 - mu;
        const float var = wave_sum((d0[0] * d0[0] + d0[1] * d0[1]) + (d0[2] * d0[2] + d0[3] * d0[3]) + (d1[0] * d1[0] + d1[1] * d1[1]) + (d1[2] * d1[2] + d1[3] * d1[3])) * (1.f / 512.f);
        const float rs = rsqrtf(var + EPS);
        const f32x4 o0 = d0 * rs * g0 + b0, o1 = d1 * rs * g1 + b1;
        u32x4 wv; wv.x = cvt_pk_bf16(fsilu(o0[0]), fsilu(o0[1])); wv.y = cvt_pk_bf16(fsilu(o0[2]), fsilu(o0[3])); wv.z = cvt_pk_bf16(fsilu(o1[0]), fsilu(o1[1])); wv.w = cvt_pk_bf16(fsilu(o1[2]), fsilu(o1[3]));
        *(u32x4*)(MIX + (size_t)(rowbase + t0 + t) * D + lane * 8) = wv;
    }
    __syncthreads();
}

constexpr int P128 = 136;
__device__ __forceinline__ bf16x8 lds_row8(const LAS bf16_t* base, int row, int col, int pitch) { return *(const LAS bf16x8*)(base + row * pitch + col); }
__device__ __forceinline__ bf16x8 lds_col8(const LAS bf16_t* base, int row0, int col, int pitch) {
    bf16x8 r;
#pragma unroll
    for (int i = 0; i < 8; ++i) r[i] = (short)base[(row0 + i) * pitch + col];
    return r;
}
__device__ __forceinline__ void stage128(LAS bf16_t* dst, const bf16_t* src, int nrows) {
    for (int idx = threadIdx.x; idx < nrows * 16; idx += NTHREADS) { const int r = idx >> 4, ch = idx & 15;
        *(LAS u32x4*)(dst + r * P128 + ch * 8) = *(const u32x4*)(src + (size_t)r * 512 + ch * 8); }
}
__device__ __forceinline__ void hgrn_state_update(const LAS bf16_t* kd_s, const LAS bf16_t* v_s, int nrows, const float* gl, const float* S0, float* outS) {
    const int lane = threadIdx.x & 63, wave = threadIdx.x >> 6, fr = lane & 15, fq = lane >> 4;
    f32x4 acc[8];
#pragma unroll
    for (int nt = 0; nt < 8; ++nt) acc[nt] = (f32x4){0.f, 0.f, 0.f, 0.f};
    for (int ks = 0; ks < nrows / 32; ++ks) {
        const bf16x8 a = lds_col8(kd_s, ks * 32 + fq * 8, wave * 16 + fr, P128);
#pragma unroll
        for (int nt = 0; nt < 8; ++nt) { const bf16x8 b = lds_col8(v_s, ks * 32 + fq * 8, nt * 16 + fr, P128); acc[nt] = __builtin_amdgcn_mfma_f32_16x16x32_bf16(a, b, acc[nt], 0, 0, 0); }
    }
#pragma unroll
    for (int j = 0; j < 4; ++j) {
        const int k = wave * 16 + fq * 4 + j; const float e = __expf(gl[k]);
#pragma unroll
        for (int nt = 0; nt < 8; ++nt) { const int v = nt * 16 + fr; float x = acc[nt][j]; if (S0) x += S0[k * 128 + v]; outS[k * 128 + v] = x * e; }
    }
}
__device__ __forceinline__ void hg1_item(const Params& p, LAS unsigned char* lds, int item) {
    unsigned char* ws = p.ws;
    const int cid = item >> 2, h = item & 3, r0 = cid * 64;
    LAS bf16_t* kd_s = (LAS bf16_t*)lds; LAS bf16_t* v_s = kd_s + 64 * P128;
    stage128(kd_s, (const bf16_t*)(ws + WS_KD) + (size_t)r0 * 512 + h * 128, 64);
    stage128(v_s, (const bf16_t*)(ws + WS_V) + (size_t)r0 * 512 + h * 128, 64);
    __syncthreads();
    hgrn_state_update(kd_s, v_s, 64, (const float*)(ws + WS_GL) + (size_t)cid * 512 + h * 128, nullptr, (float*)(ws + WS_KV) + (size_t)item * 16384);
    __syncthreads();
}
__device__ __forceinline__ void hg2_scan(const Params& p) {
    unsigned char* ws = p.ws; float* KV = (float*)(ws + WS_KV); const float* GL = (const float*)(ws + WS_GL);
    for (int gid = blockIdx.x * NTHREADS + threadIdx.x; gid < 32 * 4096; gid += gridDim.x * NTHREADS) {
        const int chain = gid >> 12, b = chain >> 2, h = chain & 3, e4 = gid & 4095, k = e4 >> 5, v4 = (e4 & 31) * 4;
        f32x4 S = (f32x4){0.f, 0.f, 0.f, 0.f};
#pragma unroll 8
        for (int c = 0; c < 32; ++c) {
            const int cid = b * 32 + c;
            f32x4* q = (f32x4*)(KV + (size_t)(cid * 4 + h) * 16384 + k * 128 + v4);
            const f32x4 kv = *q; *q = S;
            S = S * __expf(GL[(size_t)cid * 512 + h * 128 + k]) + kv;
        }
        *(f32x4*)(p.out + O_HGRNP + (size_t)chain * 16384 + k * 128 + v4) = S;
    }
}
__device__ __forceinline__ void hg3_item(const Params& p, LAS unsigned char* lds, int item) {
    unsigned char* ws = p.ws;
    const int tid = threadIdx.x, lane = tid & 63, wave = tid >> 6, fr = lane & 15, fq = lane >> 4;
    int r0, h, nrows, glrow; const float* Ssrc;
    if (item < 1024) { const int cid = item >> 2; h = item & 3; r0 = cid * 64; nrows = 64; glrow = cid; Ssrc = (const float*)(ws + WS_KV) + (size_t)item * 16384; }
    else { const int it = item - 1024, b = it >> 2; h = it & 3; r0 = MP + b * 32; nrows = 32; glrow = 256 + b; Ssrc = p.in[I_SHGRN] + (size_t)(b * 4 + h) * 16384; }
    LAS bf16_t* qd_s = (LAS bf16_t*)lds; LAS bf16_t* kd_s = qd_s + 64 * P128; LAS bf16_t* v_s = kd_s + 64 * P128; LAS bf16_t* S_s = v_s + 64 * P128;
    LAS bf16_t* P_s = S_s + 128 * P128;
    LAS float* red = (LAS float*)(P_s + 64 * 72);
    stage128(qd_s, (const bf16_t*)(ws + WS_QD) + (size_t)r0 * 512 + h * 128, nrows);
    stage128(kd_s, (const bf16_t*)(ws + WS_KD) + (size_t)r0 * 512 + h * 128, nrows);
    stage128(v_s, (const bf16_t*)(ws + WS_V) + (size_t)r0 * 512 + h * 128, nrows);
    for (int idx = tid; idx < 128 * 32; idx += NTHREADS) { const int k = idx >> 5, c4 = (idx & 31) * 4; const f32x4 s = *(const f32x4*)(Ssrc + k * 128 + c4);
        u32x2 w; w.x = cvt_pk_bf16(s[0], s[1]); w.y = cvt_pk_bf16(s[2], s[3]); *(LAS u32x2*)(S_s + k * P128 + c4) = w; }
    __syncthreads();
    const int tt = wave & 3, hh = wave >> 2;
    const bool act_t = tt * 16 < nrows;
    if (act_t && hh * 32 < nrows) {
        f32x4 sc[2] = {(f32x4){0.f, 0.f, 0.f, 0.f}, (f32x4){0.f, 0.f, 0.f, 0.f}};
#pragma unroll
        for (int ks = 0; ks < 4; ++ks) {
            const bf16x8 a = lds_row8(qd_s, tt * 16 + fr, ks * 32 + fq * 8, P128);
#pragma unroll
            for (int nt = 0; nt < 2; ++nt) { const bf16x8 b = lds_row8(kd_s, hh * 32 + nt * 16 + fr, ks * 32 + fq * 8, P128); sc[nt] = __builtin_amdgcn_mfma_f32_16x16x32_bf16(a, b, sc[nt], 0, 0, 0); }
        }
#pragma unroll
        for (int nt = 0; nt < 2; ++nt)
#pragma unroll
            for (int j = 0; j < 4; ++j) { const int t = tt * 16 + fq * 4 + j, s = hh * 32 + nt * 16 + fr;
                const float x = (s <= t) ? sc[nt][j] : 0.f; P_s[t * 72 + s] = (bf16_t)(cvt_pk_bf16(x, 0.f) & 0xffffu); }
    }
    __syncthreads();
    f32x4 o[4];
#pragma unroll
    for (int nt = 0; nt < 4; ++nt) o[nt] = (f32x4){0.f, 0.f, 0.f, 0.f};
    if (act_t) {
        for (int ks = 0; ks < nrows / 32; ++ks) {
            const bf16x8 a = lds_row8(P_s, tt * 16 + fr, ks * 32 + fq * 8, 72);
#pragma unroll
            for (int nt = 0; nt < 4; ++nt) { const bf16x8 b = lds_col8(v_s, ks * 32 + fq * 8, hh * 64 + nt * 16 + fr, P128); o[nt] = __builtin_amdgcn_mfma_f32_16x16x32_bf16(a, b, o[nt], 0, 0, 0); }
        }
#pragma unroll
        for (int ks = 0; ks < 4; ++ks) {
            const bf16x8 a = lds_row8(qd_s, tt * 16 + fr, ks * 32 + fq * 8, P128);
#pragma unroll
            for (int nt = 0; nt < 4; ++nt) { const bf16x8 b = lds_col8(S_s, ks * 32 + fq * 8, hh * 64 + nt * 16 + fr, P128); o[nt] = __builtin_amdgcn_mfma_f32_16x16x32_bf16(a, b, o[nt], 0, 0, 0); }
        }
#pragma unroll
        for (int j = 0; j < 4; ++j) {
            float s = (o[0][j] * o[0][j] + o[1][j] * o[1][j]) + (o[2][j] * o[2][j] + o[3][j] * o[3][j]);
            s += __shfl_xor(s, 1); s += __shfl_xor(s, 2); s += __shfl_xor(s, 4); s += __shfl_xor(s, 8);
            if (fr == 0) red[(tt * 16 + fq * 4 + j) * 2 + hh] = s;
        }
    }
    __syncthreads();
    if (act_t) {
        const bf16_t* SG = (const bf16_t*)(ws + WS_SG); bf16_t* MIX = (bf16_t*)(ws + WS_B0); const float* gn = p.in[I_HNORM] + h * 128;
#pragma unroll
        for (int j = 0; j < 4; ++j) {
            const int t = tt * 16 + fq * 4 + j;
            const float rs = rsqrtf((red[t * 2] + red[t * 2 + 1]) * (1.f / 128.f) + EPS);
#pragma unroll
            for (int nt = 0; nt < 4; ++nt) { const int v = hh * 64 + nt * 16 + fr;
                const float y = o[nt][j] * rs * gn[v] * bf2f(SG[(size_t)(r0 + t) * 512 + h * 128 + v]);
                MIX[(size_t)(r0 + t) * D + 512 + h * 128 + v] = (bf16_t)(cvt_pk_bf16(y, 0.f) & 0xffffu); }
        }
    }
    if (item >= 1024) {
        const int it = item - 1024;
        hgrn_state_update(kd_s, v_s, 32, (const float*)(ws + WS_GL) + (size_t)glrow * 512 + h * 128, Ssrc, p.out + O_HGRNS + (size_t)it * 16384);
    }
    __syncthreads();
}

constexpr int PQ = 264, PK = 72;
__device__ __forceinline__ void attn_item(const Params& p, LAS unsigned char* lds, int item) {
    unsigned char* ws = p.ws;
    const int tid = threadIdx.x, lane = tid & 63, wave = tid >> 6, fr = lane & 15, fq = lane >> 4;
    int r0, h, nrows, vtp; const bf16_t *Kg, *Vt;
    if (item < 1024) { const int b = item >> 7, rem = item & 127; h = rem >> 5; const int tile = rem & 31; r0 = b * SEQ + tile * 64; nrows = 64;
        Kg = (const bf16_t*)(ws + WS_KB) + (size_t)b * NMEM * D + h * 256; Vt = (const bf16_t*)(ws + WS_VTP) + (size_t)(h * 256) * 2048 + b * 256; vtp = 2048; }
    else { const int it = item - 1024, b = it >> 2; h = it & 3; r0 = MP + b * 32; nrows = 32;
        Kg = (const bf16_t*)(ws + WS_KB) + (size_t)(2048 + b * NMEM) * D + h * 256; Vt = (const bf16_t*)(ws + WS_VTS) + (size_t)b * D * 256 + (size_t)(h * 256) * 256; vtp = 256; }
    const bf16_t* Q = (const bf16_t*)(ws + WS_B0); bf16_t* O = (bf16_t*)(ws + WS_B1);
    LAS bf16_t* kv_s = (LAS bf16_t*)lds;
    LAS bf16_t* q_s = kv_s + 256 * PK;
    LAS bf16_t* p_s = q_s + 64 * PQ;
    LAS float* red = (LAS float*)(p_s + 64 * PQ);
    for (int idx = tid; idx < nrows * 32; idx += NTHREADS) { const int r = idx >> 5, ch = idx & 31;
        *(LAS u32x4*)(q_s + r * PQ + ch * 8) = *(const u32x4*)(Q + (size_t)(r0 + r) * D + h * 256 + ch * 8); }
    const int tt = wave & 3, mh = wave >> 2;
    const bool act = tt * 16 < nrows;
    f32x4 sc[8];
#pragma unroll
    for (int nt = 0; nt < 8; ++nt) sc[nt] = (f32x4){0.f, 0.f, 0.f, 0.f};
    for (int dh = 0; dh < 4; ++dh) {
        for (int idx = tid; idx < 256 * 8; idx += NTHREADS) { const int mem = idx >> 3, ch = idx & 7;
            *(LAS u32x4*)(kv_s + mem * PK + ch * 8) = *(const u32x4*)(Kg + (size_t)mem * D + dh * 64 + ch * 8); }
        __syncthreads();
        if (act) {
#pragma unroll
            for (int ks = 0; ks < 2; ++ks) {
                const bf16x8 a = lds_row8(q_s, tt * 16 + fr, dh * 64 + ks * 32 + fq * 8, PQ);
#pragma unroll
                for (int nt = 0; nt < 8; ++nt) { const bf16x8 b = lds_row8(kv_s, mh * 128 + nt * 16 + fr, ks * 32 + fq * 8, PK); sc[nt] = __builtin_amdgcn_mfma_f32_16x16x32_bf16(a, b, sc[nt], 0, 0, 0); }
            }
        }
        __syncthreads();
    }
    if (act) {
#pragma unroll
        for (int j = 0; j < 4; ++j) {
            float mx = sc[0][j];
#pragma unroll
            for (int nt = 1; nt < 8; ++nt) mx = fmaxf(mx, sc[nt][j]);
            mx = fmaxf(mx, __shfl_xor(mx, 1)); mx = fmaxf(mx, __shfl_xor(mx, 2)); mx = fmaxf(mx, __shfl_xor(mx, 4)); mx = fmaxf(mx, __shfl_xor(mx, 8));
            if (fr == 0) red[(tt * 16 + fq * 4 + j) * 2 + mh] = mx;
        }
    }
    __syncthreads();
    if (act) {
#pragma unroll
        for (int j = 0; j < 4; ++j) {
            const int t = tt * 16 + fq * 4 + j;
            const float gm = fmaxf(red[t * 2], red[t * 2 + 1]);
            float sum = 0.f;
#pragma unroll
            for (int nt = 0; nt < 8; ++nt) { const float e = __expf(sc[nt][j] - gm); sc[nt][j] = e; sum += e; }
            sum += __shfl_xor(sum, 1); sum += __shfl_xor(sum, 2); sum += __shfl_xor(sum, 4); sum += __shfl_xor(sum, 8);
            if (fr == 0) red[128 + t * 2 + mh] = sum;
        }
    }
    __syncthreads();
    if (act) {
#pragma unroll
        for (int j = 0; j < 4; ++j) {
            const int t = tt * 16 + fq * 4 + j;
            const float inv = 1.f / (red[128 + t * 2] + red[128 + t * 2 + 1]);
#pragma unroll
            for (int nt = 0; nt < 8; ++nt) p_s[t * PQ + mh * 128 + nt * 16 + fr] = (bf16_t)(cvt_pk_bf16(sc[nt][j] * inv, 0.f) & 0xffffu);
#ifdef MK_P_ONLY
#pragma unroll
            for (int nt = 0; nt < 8; ++nt) O[(size_t)(r0 + t) * D + h * 256 + mh * 128 + nt * 16 + fr] = (bf16_t)(cvt_pk_bf16(sc[nt][j] * inv * 64.f, 0.f) & 0xffffu);
#endif
        }
    }
    __syncthreads();
#ifdef MK_P_ONLY
    return;
#endif
    f32x4 o[4][2];
#pragma unroll
    for (int dh = 0; dh < 4; ++dh) { o[dh][0] = (f32x4){0.f, 0.f, 0.f, 0.f}; o[dh][1] = (f32x4){0.f, 0.f, 0.f, 0.f}; }
#pragma unroll
    for (int dh = 0; dh < 4; ++dh) {
        for (int idx = tid; idx < 64 * 32; idx += NTHREADS) { const int d = idx >> 5, ch = idx & 31;
            *(LAS u32x4*)(kv_s + d * PQ + ch * 8) = *(const u32x4*)(Vt + (size_t)(dh * 64 + d) * vtp + ch * 8); }
        __syncthreads();
        if (act) {
#pragma unroll
            for (int ks = 0; ks < 8; ++ks) {
                const bf16x8 a = lds_row8(p_s, tt * 16 + fr, ks * 32 + fq * 8, PQ);
#pragma unroll
                for (int nt = 0; nt < 2; ++nt) { const bf16x8 b = lds_row8(kv_s, mh * 32 + nt * 16 + fr, ks * 32 + fq * 8, PQ); o[dh][nt] = __builtin_amdgcn_mfma_f32_16x16x32_bf16(a, b, o[dh][nt], 0, 0, 0); }
            }
        }
        __syncthreads();
    }
    if (act) {
#pragma unroll
        for (int dh = 0; dh < 4; ++dh)
#pragma unroll
            for (int j = 0; j < 4; ++j) { const int t = tt * 16 + fq * 4 + j;
#pragma unroll
                for (int nt = 0; nt < 2; ++nt) O[(size_t)(r0 + t) * D + h * 256 + dh * 64 + mh * 32 + nt * 16 + fr] = (bf16_t)(cvt_pk_bf16(o[dh][nt][j], 0.f) & 0xffffu); }
    }
}

__device__ __forceinline__ void final_norm(const Params& p) {
    const int lane = threadIdx.x & 63, wave = threadIdx.x >> 6;
    const int gw = blockIdx.x * NWAVES + wave, NGW = gridDim.x * NWAVES;
    f32x4 g[4];
#pragma unroll
    for (int j = 0; j < 4; ++j) g[j] = *((const f32x4*)p.in[I_FINN] + lane + 64 * j);
    for (int m = gw; m < M; m += NGW) {
        f32x4* xr = (f32x4*)(p.out + O_Y + (size_t)m * D) + lane;
        f32x4 v[4]; float s = 0.f;
#pragma unroll
        for (int j = 0; j < 4; ++j) { v[j] = xr[64 * j]; s += (v[j][0] * v[j][0] + v[j][1] * v[j][1]) + (v[j][2] * v[j][2] + v[j][3] * v[j][3]); }
        const float rs = rsqrtf(wave_sum(s) * (1.f / 1024.f) + EPS);
#pragma unroll
        for (int j = 0; j < 4; ++j) xr[64 * j] = v[j] * rs * g[j];
    }
}

constexpr int NPHASES = 14;
__global__ void __launch_bounds__(NTHREADS) mega(Params p) {
    extern __shared__ __attribute__((aligned(16))) unsigned char lds_raw[];
    LAS unsigned char* lds = (LAS unsigned char*)lds_raw;
    unsigned char* ws = p.ws;
    const int G = gridDim.x, bx = blockIdx.x;
#define IN(k) (p.ph_lo <= (k) && (k) < p.ph_hi)
#define SEAM(k) do { if (IN(k) && IN((k) + 1)) cg::this_grid().sync(); } while (0)

    float* X = p.out + O_Y;
    bf16_t* B0 = (bf16_t*)(ws + WS_B0); bf16_t* B1 = (bf16_t*)(ws + WS_B1); bf16_t* H = (bf16_t*)(ws + WS_HZ);
    float* SSQ1 = (float*)(ws + WS_SSQ1); float* SSQ2 = (float*)(ws + WS_SSQ2); float* SSQ3 = (float*)(ws + WS_SSQ3);

    if (IN(0)) { phase_prologue(p, lds); }
    SEAM(0);
    if (IN(1)) {
        { pg8::Gemm g{B0, (const bf16_t*)(ws + WS_WGU1), M, 2 * FF, D}; pg8::StaticOrder S; S.init(M, 2 * FF, G, bx);
          EpiSwiGLU E{H, (const float*)(ws + WS_RSTD0), nullptr}; pg8::gemm_phase(lds, g, S, E); }
    }
    SEAM(1);
    if (IN(2)) {
        pg8::Gemm g{H, (const bf16_t*)(ws + WS_WD1), M, D, FF}; pg8::StaticOrder S; S.init(M, D, G, bx);
        EpiResid E{p.in[I_XP], p.in[I_XS], X, B0, SSQ1, 0.5f}; pg8::gemm_phase(lds, g, S, E);
    }
    SEAM(2);
    if (IN(3)) {
        pg8::Gemm g{B0, (const bf16_t*)(ws + WS_WIN), M, 3072, D}; pg8::StaticOrder S; S.init(M, 3072, G, bx);
        EpiWin E{SSQ1, (const float*)(ws + WS_LB), (bf16_t*)(ws + WS_U), (bf16_t*)(ws + WS_QD), (bf16_t*)(ws + WS_KD), (bf16_t*)(ws + WS_V), (bf16_t*)(ws + WS_SG),
                 (float*)(ws + WS_GL), p.out + O_CONVP, p.out + O_CONVS};
        pg8::gemm_phase(lds, g, S, E);
    }
    SEAM(3);
    if (IN(4)) {
        for (int it = bx; it < 1024; it += G) hg1_item(p, lds, it);
        for (int it = bx; it < 528; it += G) conv_item(p, lds, it);
    }
    SEAM(4);
    if (IN(5)) { hg2_scan(p); }
    SEAM(5);
    if (IN(6)) { for (int it = bx; it < 1024 + 64; it += G) hg3_item(p, lds, it); }
    SEAM(6);
    if (IN(7)) {
        pg8::Gemm g{B0, (const bf16_t*)(ws + WS_WOUT), M, D, D}; pg8::StaticOrder S; S.init(M, D, G, bx);
        EpiResid E{X, X + (size_t)MP * D, X, B1, SSQ2, 1.f}; pg8::gemm_phase(lds, g, S, E);
    }
    SEAM(7);
    if (IN(8)) {
        pg8::Gemm g{B1, (const bf16_t*)(ws + WS_WQ), M, D, D}; pg8::StaticOrder S; S.init(M, D, G, bx);
        sample_kv_convert(p, lds);
        EpiScaleBf16 E{B0, SSQ2}; pg8::gemm_phase(lds, g, S, E);
        const int first_free = (66 * 4) % G;
        { pg8::Gemm g2{(const bf16_t*)(ws + WS_MB), (const bf16_t*)(ws + WS_WKV), 2048, 2048, D}; pg8::StaticOrder S2; S2.init(2048, 2048, G, (bx + G - first_free) % G);
          EpiMemKV E2{p.out + O_MK, p.out + O_MV, (const float*)(ws + WS_RSTDM), (bf16_t*)(ws + WS_KB)}; pg8::gemm_phase(lds, g2, S2, E2); }
        { pg8::Gemm g3{(const bf16_t*)(ws + WS_WKV) + (size_t)1024 * D, (const bf16_t*)(ws + WS_MB), 1024, 2048, D}; pg8::StaticOrder S3; S3.init(1024, 2048, G, (bx + G - (first_free + 64) % G) % G);
          EpiVT E3{(bf16_t*)(ws + WS_VTP), (const float*)(ws + WS_RSTDM)}; pg8::gemm_phase(lds, g3, S3, E3); }
    }
    SEAM(8);
#ifndef MK_SKIP_ATTN
    if (IN(9)) { for (int it = bx; it < 1024 + 64; it += G) attn_item(p, lds, it); }
#endif
    SEAM(9);
#ifdef MK_DUMP_B1
    if (IN(10)) { for (size_t i = (size_t)bx * NTHREADS + threadIdx.x; i < (size_t)M * D; i += (size_t)G * NTHREADS) X[i] = bf2f(MK_DUMP_SRC[i]); }
    if (0) {
#else
    if (IN(10)) {
#endif
        pg8::Gemm g{B1, (const bf16_t*)(ws + WS_WO), M, D, D}; pg8::StaticOrder S; S.init(M, D, G, bx);
                EpiResid E{X, X + (size_t)MP * D, X, B0, SSQ3, 1.f}; pg8::gemm_phase(lds, g, S, E);
    }
    SEAM(10);
    if (IN(11)) {
        pg8::Gemm g{B0, (const bf16_t*)(ws + WS_WGU2), M, 2 * FF, D}; pg8::StaticOrder S; S.init(M, 2 * FF, G, bx);
        EpiSwiGLU E{H, nullptr, SSQ3}; pg8::gemm_phase(lds, g, S, E);
    }
    SEAM(11);
    if (IN(12)) {
        pg8::Gemm g{H, (const bf16_t*)(ws + WS_WD2), M, D, FF}; pg8::StaticOrder S; S.init(M, D, G, bx);
        EpiResid E{X, X + (size_t)MP * D, X, nullptr, nullptr, 0.5f}; pg8::gemm_phase(lds, g, S, E);
    }
    SEAM(12);
    if (IN(13)) { final_norm(p); }
#ifdef MK_DBG_MASK
    if (IN(14)) {
        const size_t offs[9] = {O_Y, O_Y + (size_t)MP * D, O_CONVP, O_HGRNP, O_MK, O_MV, O_CONVS, O_HGRNS, O_HGRNS + (size_t)NDB * 4 * 128 * 128};
        for (int j = 0; j < 8; ++j) if ((MK_DBG_MASK >> j) & 1)
            for (size_t i = offs[j] + (size_t)bx * NTHREADS + threadIdx.x; i < offs[j + 1]; i += (size_t)G * NTHREADS) p.out[i] *= 0.75f;
    }
#endif
#undef IN
#undef SEAM
}

extern "C" void kernel_launch(void* const* d_in, const int* in_sizes, int n_in, void* d_out, int out_size, void* d_ws, size_t ws_size, hipStream_t stream) {
    static int grid = 0;
    if (grid == 0) {
        if (n_in != 31 || ws_size < WS_END) { fprintf(stderr, "kernel_launch: unexpected n_in %d / ws %zu (need %zu)\n", n_in, ws_size, (size_t)WS_END); grid = -1; return; }
        int dev = 0, cus = 0, per_cu = 0;
        (void)hipGetDevice(&dev); (void)hipDeviceGetAttribute(&cus, hipDeviceAttributeMultiprocessorCount, dev);
        if (hipFuncSetAttribute((const void*)mega, hipFuncAttributeMaxDynamicSharedMemorySize, LDS_BYTES) != hipSuccess) { fprintf(stderr, "kernel_launch: hipFuncSetAttribute failed\n"); grid = -1; return; }
        if (hipOccupancyMaxActiveBlocksPerMultiprocessor(&per_cu, (const void*)mega, NTHREADS, LDS_BYTES) != hipSuccess || per_cu < 1) per_cu = 1;
        (void)hipGetLastError();
        grid = cus * per_cu;
        if (grid <= 0) grid = 256;
    }
    if (grid < 0) return;
    Params p{};
    for (int i = 0; i < 31; ++i) p.in[i] = (const float*)d_in[i];
    p.out = (float*)d_out; p.ws = (unsigned char*)d_ws;
#if MK_MULTI
    for (int ph = 0; ph < MK_NPH; ++ph) { p.ph_lo = ph; p.ph_hi = ph + 1; hipLaunchKernelGGL(mega, dim3(grid), dim3(NTHREADS), LDS_BYTES, stream, p); }
#else
    p.ph_lo = 0; p.ph_hi = MK_NPH;
    void* args[] = {&p};
    hipError_t e = hipLaunchCooperativeKernel((const void*)mega, dim3(grid), dim3(NTHREADS), args, LDS_BYTES, stream);
    if (e != hipSuccess) fprintf(stderr, "cooperative launch failed: %s (grid %d)\n", hipGetErrorString(e), grid);
#endif
}
```
